# Optimizing an MI355X kernel written in HIP

```python
import math
import jax, jax.numpy as jnp
from jax import lax
import numpy as np

D_MODEL = 1024
BATCH = 1
SEQ = 16384
DEPTH = 1
DEC_BATCH = 128
DEC_SEQ = 1
PAST_LEN = 8192
PAGE_SIZE = 128

HEAD_DIM = 128
HEADS_PER_GROUP = 4
GROUPS = ((128, 1), (512, 4), (2048, 16))
N_GROUPS = len(GROUPS)
N_HEADS = N_GROUPS * HEADS_PER_GROUP
ATTN_QKV = N_HEADS * HEAD_DIM
ATTN_OUT = HEADS_PER_GROUP * HEAD_DIM
CONV_CH = D_MODEL // 2
CONV_WIDTH = 31
ALPHA = (2.0 * DEPTH) ** 0.25
BETA = (8.0 * DEPTH) ** -0.25
LN_EPS = 1e-5
NEG = -1e30
IN_SIZES = (ATTN_QKV, ATTN_QKV, ATTN_QKV, ATTN_OUT, 2 * CONV_CH, CONV_CH, D_MODEL, D_MODEL)
IN_COLS = sum(IN_SIZES)
SPLIT_POINTS = tuple(int(s) for s in np.cumsum(IN_SIZES)[:-1])

kernel_name = "hybrid_dilated_swa_conformer_conv_decode_step"


def _alibi_slopes():
    h = jnp.arange(1, N_HEADS + 1, dtype=jnp.float32)
    return (2.0 ** (-8.0 * h / N_HEADS)).reshape(N_GROUPS, HEADS_PER_GROUP)


def _layer_norm(x, g, b):
    xf = x.astype(jnp.float32)
    mu = jnp.mean(xf, axis=-1, keepdims=True)
    var = jnp.mean(jnp.square(xf - mu), axis=-1, keepdims=True)
    return ((xf - mu) * lax.rsqrt(var + LN_EPS) * g.astype(jnp.float32) + b.astype(jnp.float32)).astype(x.dtype)


def _branches_in(x, c, w_c, b_c, w_in, b_in):
    mod = c @ w_c + b_c
    shift, scale, gate = jnp.split(mod, 3, axis=-1)
    h = x * (1.0 + scale[:, None]) + shift[:, None]
    z = h @ w_in + b_in
    return gate, jnp.split(z, SPLIT_POINTS, axis=-1)


def _heads(a):
    return a.reshape(a.shape[0], a.shape[1], N_GROUPS, HEADS_PER_GROUP, HEAD_DIM)


def _dilated_window_prompt(q, k, v, slopes, window, dilation):
    B, L, H, Dh = q.shape
    n_keys = window // dilation
    blk = n_keys
    span = dilation * blk
    Lp = -(-L // span) * span
    nb = Lp // span
    ls = Lp // dilation

    def split(a):
        a = jnp.pad(a, ((0, 0), (0, Lp - L), (0, 0), (0, 0)))
        a = a.reshape(B, ls, dilation, H, Dh).transpose(0, 2, 1, 3, 4)
        return a.reshape(B, dilation, nb, blk, H, Dh)

    def with_prev(a):
        prev = jnp.pad(a, ((0, 0), (0, 0), (1, 0), (0, 0), (0, 0), (0, 0)))[:, :, :-1]
        return jnp.concatenate([prev, a], axis=3)

    qb = split(q)
    kk = with_prev(split(k))
    vv = with_prev(split(v))
    s = jnp.einsum('bdnqhe,bdnkhe->bdnhqk', qb, kk).astype(jnp.float32)
    qi = jnp.arange(blk)
    ki = jnp.arange(2 * blk) - blk
    dist = qi[:, None] - ki[None, :]
    in_range = (dist >= 0) & (dist <= n_keys)
    after_start = (jnp.arange(nb)[:, None, None] * blk + ki[None, None, :]) >= 0
    mask = in_range[None] & after_start
    bias = -(slopes[:, None, None] * (dilation * dist).astype(jnp.float32)[None])
    s = jnp.where(mask[None, None, :, None], s + bias, NEG)
    lse = jax.nn.logsumexp(s, axis=-1)
    p = jnp.exp(s - lse[..., None])
    o = jnp.einsum('bdnhqk,bdnkhe->bdnqhe', p, vv.astype(jnp.float32))
    o = o.reshape(B, dilation, ls, H, Dh).transpose(0, 2, 1, 3, 4).reshape(B, Lp, H, Dh)[:, :L]
    lse = lse.transpose(0, 1, 2, 4, 3).reshape(B, dilation, ls, H).transpose(0, 2, 1, 3).reshape(B, Lp, H)[:, :L]
    return o, lse


def _dilated_window_sample(q, k_new, v_new, kv_cache, slopes, window, dilation):
    S = q.shape[1]
    Wb = kv_cache.shape[1]
    n_keys = window // dilation
    k_all = jnp.concatenate([kv_cache[:, :, 0], k_new.astype(kv_cache.dtype)], axis=1)
    v_all = jnp.concatenate([kv_cache[:, :, 1], v_new.astype(kv_cache.dtype)], axis=1)
    steps = jnp.arange(n_keys + 1)
    idx = Wb + jnp.arange(S)[:, None] - dilation * steps[None, :]
    valid = idx >= 0
    idx_c = jnp.maximum(idx, 0)
    kg = k_all[:, idx_c]
    vg = v_all[:, idx_c]
    s = jnp.einsum('bshe,bskhe->bhsk', q, kg.astype(q.dtype)).astype(jnp.float32)
    bias = -(slopes[:, None, None] * (dilation * steps).astype(jnp.float32)[None, None, :])
    s = jnp.where(valid[None, None], s + bias, NEG)
    lse = jax.nn.logsumexp(s, axis=-1)
    p = jnp.exp(s - lse[..., None])
    o = jnp.einsum('bhsk,bskhe->bshe', p, vg.astype(jnp.float32))
    return o, lse.transpose(0, 2, 1)


def _combine_groups(outs, lses):
    w = jax.nn.softmax(jnp.stack(lses, axis=0), axis=0)
    return jnp.sum(w[..., None] * jnp.stack(outs, axis=0), axis=0)


def _glu(u2):
    a, g = jnp.split(u2, 2, axis=-1)
    return a * jax.nn.sigmoid(g)


def _conv_tail(u_ext, conv_w, conv_b, cn_g, cn_b):
    y = lax.conv_general_dilated(u_ext, conv_w[:, None, :].astype(u_ext.dtype), window_strides=(1,),
                                 padding='VALID', dimension_numbers=('NWC', 'WIO', 'NWC'),
                                 feature_group_count=CONV_CH)
    y = y + conv_b
    return jax.nn.silu(_layer_norm(y, cn_g, cn_b))


def _branches_out(x, gate, o_attn, ga, conv_out, gb, ma, mb, w_pa, w_pb, w_o, ln_g, ln_b):
    B, T = x.shape[0], x.shape[1]
    a = (o_attn.reshape(B, T, ATTN_OUT).astype(x.dtype) * jax.nn.silu(ga)) @ w_pa
    b = (conv_out * jax.nn.silu(gb)) @ w_pb
    y = (jax.nn.sigmoid(ma) * a + jax.nn.sigmoid(mb) * b) @ w_o
    return _layer_norm(ALPHA * x + gate[:, None] * y, ln_g, ln_b)


def setup_inputs(seed: int = 0) -> dict:
    key = jax.random.key(seed)
    ks = jax.random.split(key, 24)
    f32 = jnp.float32

    def nrm(k, shape, s):
        return jax.random.normal(k, shape, f32) * s

    w_bufs = [min(w, PAST_LEN) for w, _ in GROUPS]
    w_in = nrm(ks[8], (D_MODEL, IN_COLS), D_MODEL ** -0.5)
    w_in = w_in.at[:, 2 * ATTN_QKV:3 * ATTN_QKV].multiply(BETA)
    return {
        "x_prompt": nrm(ks[0], (BATCH, SEQ, D_MODEL), 1.0),
        "x_sample": nrm(ks[1], (DEC_BATCH, DEC_SEQ, D_MODEL), 1.0),
        "c_prompt": nrm(ks[2], (BATCH, D_MODEL), 1.0),
        "c_sample": nrm(ks[3], (DEC_BATCH, D_MODEL), 1.0),
        "cache_kv_w128": nrm(ks[4], (DEC_BATCH, w_bufs[0], 2, HEADS_PER_GROUP, HEAD_DIM), 1.0),
        "cache_kv_w512": nrm(ks[5], (DEC_BATCH, w_bufs[1], 2, HEADS_PER_GROUP, HEAD_DIM), 1.0),
        "cache_kv_w2048": nrm(ks[6], (DEC_BATCH, w_bufs[2], 2, HEADS_PER_GROUP, HEAD_DIM), 1.0),
        "state_conv": nrm(ks[7], (DEC_BATCH, CONV_WIDTH - 1, CONV_CH), 0.5),
        "w_c": nrm(ks[9], (D_MODEL, 3 * D_MODEL), 0.5 * D_MODEL ** -0.5),
        "b_c": nrm(ks[10], (3 * D_MODEL,), 0.02),
        "w_in": w_in,
        "b_in": nrm(ks[11], (IN_COLS,), 0.02),
        "conv_w": nrm(ks[12], (CONV_WIDTH, CONV_CH), CONV_WIDTH ** -0.5),
        "conv_b": nrm(ks[13], (CONV_CH,), 0.02),
        "conv_norm_g": 1.0 + nrm(ks[14], (CONV_CH,), 0.02),
        "conv_norm_b": nrm(ks[15], (CONV_CH,), 0.02),
        "w_pa": nrm(ks[16], (ATTN_OUT, D_MODEL), BETA * ATTN_OUT ** -0.5),
        "w_pb": nrm(ks[17], (CONV_CH, D_MODEL), BETA * CONV_CH ** -0.5),
        "w_o": nrm(ks[18], (D_MODEL, D_MODEL), BETA * D_MODEL ** -0.5),
        "ln_g": 1.0 + nrm(ks[19], (D_MODEL,), 0.02),
        "ln_b": nrm(ks[20], (D_MODEL,), 0.02),
    }


def reference(x_prompt, x_sample, c_prompt, c_sample, cache_kv_w128, cache_kv_w512, cache_kv_w2048,
              state_conv, w_c, b_c, w_in, b_in, conv_w, conv_b, conv_norm_g, conv_norm_b,
              w_pa, w_pb, w_o, ln_g, ln_b):
    slopes = _alibi_slopes()
    caches = (cache_kv_w128, cache_kv_w512, cache_kv_w2048)
    seq = x_prompt.shape[1]

    x_p, x_s = x_prompt, x_sample
    for _layer in range(DEPTH):
        gate_p, (q, k, v, ga, glu, gb, ma, mb) = _branches_in(x_p, c_prompt, w_c, b_c, w_in, b_in)
        q, k, v = _heads(q) * (HEAD_DIM ** -0.5), _heads(k), _heads(v)
        outs, lses, kv_p = [], [], []
        for g, (window, dilation) in enumerate(GROUPS):
            o, l = _dilated_window_prompt(q[:, :, g], k[:, :, g], v[:, :, g], slopes[g], window, dilation)
            outs.append(o)
            lses.append(l)
            keep = min(window, seq)
            kv_p.append(jnp.stack([k[:, seq - keep:, g], v[:, seq - keep:, g]], axis=2))
        o_attn = _combine_groups(outs, lses)
        u = _glu(glu)
        u_ext = jnp.pad(u, ((0, 0), (CONV_WIDTH - 1, 0), (0, 0)))
        conv_out = _conv_tail(u_ext, conv_w, conv_b, conv_norm_g, conv_norm_b)
        conv_p = u[:, seq - (CONV_WIDTH - 1):]
        x_p = _branches_out(x_p, gate_p, o_attn, ga, conv_out, gb, ma, mb, w_pa, w_pb, w_o, ln_g, ln_b)

        gate_s, (q, k, v, ga, glu, gb, ma, mb) = _branches_in(x_s, c_sample, w_c, b_c, w_in, b_in)
        q, k, v = _heads(q) * (HEAD_DIM ** -0.5), _heads(k), _heads(v)
        outs, lses, kv_s = [], [], []
        for g, (window, dilation) in enumerate(GROUPS):
            o, l = _dilated_window_sample(q[:, :, g], k[:, :, g], v[:, :, g], caches[g], slopes[g], window, dilation)
            outs.append(o)
            lses.append(l)
            kv_s.append(jnp.stack([k[:, :, g], v[:, :, g]], axis=2))
        o_attn = _combine_groups(outs, lses)
        u = _glu(glu)
        u_ext = jnp.concatenate([state_conv.astype(u.dtype), u], axis=1)
        conv_out = _conv_tail(u_ext, conv_w, conv_b, conv_norm_g, conv_norm_b)
        conv_s = u_ext[:, u_ext.shape[1] - (CONV_WIDTH - 1):]
        x_s = _branches_out(x_s, gate_s, o_attn, ga, conv_out, gb, ma, mb, w_pa, w_pb, w_o, ln_g, ln_b)

    return (x_p, x_s, kv_p[0], kv_p[1], kv_p[2], conv_p, kv_s[0], kv_s[1], kv_s[2], conv_s)
```

```cpp
#include <hip/hip_runtime.h>
#include <cstdio>
#include <cstdint>
namespace pg8 {
#define PG8_LAS __attribute__((address_space(3)))
typedef unsigned short bf16_t;
typedef short bf16x8 __attribute__((ext_vector_type(8)));
typedef float f32x4 __attribute__((ext_vector_type(4)));
typedef unsigned u32x4 __attribute__((ext_vector_type(4)));
constexpr int BM = 256, BK = 64, HALF = 128, HTB = HALF * BK * 2  , STAGE_BYTES = 8 * HTB, NXCD = 8, WGM = 8;

__host__ __device__ __forceinline__ int lds_byte(int r, int c) { const int st = (r >> 4) * 2 + (c >> 5), rr = r & 15, cc = c & 31, ob = rr * 64 + cc * 2; return st * 1024 + (ob ^ (((ob >> 9) & 1) << 5)); }
__host__ __device__ __forceinline__ void stage_rc(int b, int& R, int& C) { const int st = b / 1024, sb = b % 1024, swz = sb ^ (((sb >> 9) & 1) << 5); R = (st >> 1) * 16 + swz / 64; C = (st & 1) * 32 + (swz % 64) / 2; }
__host__ __device__ __forceinline__ int perm32(int rho) { const int n = rho >> 4, i = rho & 15; return 8 * (i >> 2) + 4 * n + (i & 3); }

struct Unit { int pm, pn; };
struct Gemm { const bf16_t* A; const bf16_t* Bt; int M, N, K; };

struct StaticOrder {
    int nM, nN, nwg, G, c;
    __host__ __device__ void init(int M, int N, int G_, int c_) { nM = M / BM; nN = N / BM; nwg = nM * nN; G = G_; c = c_; }
    __host__ __device__ bool next(int i, Unit& u) const {
        const long L = (long)i * G + c; if (L >= nwg) return false;
        int wgid = (int)L; { const int q = nwg / NXCD, r = nwg % NXCD, xcd = wgid % NXCD, off = wgid / NXCD; wgid = (xcd < r ? xcd * (q + 1) : r * (q + 1) + (xcd - r) * q) + off; }
        const int nig = WGM * nN, gid = wgid / nig, fm = gid * WGM, gsz = (nM - fm) < WGM ? (nM - fm) : WGM;
        u.pm = fm + ((wgid % nig) % gsz); u.pn = (wgid % nig) / gsz; return true;
    }
    __device__ __forceinline__ void a_ready(const Unit&) const {}
    __device__ __forceinline__ void done(const Unit&) const {}
};

__device__ __forceinline__ unsigned cvt_pk_bf16(float lo, float hi) { unsigned r; asm volatile("v_cvt_pk_bf16_f32 %0, %1, %2" : "=v"(r) : "v"(lo), "v"(hi)); return r; }
constexpr int SEQ = 16384, NBS = 128, MROWS = SEQ + NBS  , MPAD = 16640  , ZP = 8192  ;
constexpr int ZQ = 0, ZK = 1536, ZV = 3072, ZGA = 4608, ZU = 5120, ZGB = 5632, ZMA = 6144, ZMB = 7168;
constexpr float QSCALE = 0.088388347648318440f * 1.4426950408889634f;
constexpr float LOG2E = 1.4426950408889634f;
constexpr size_t O_YP = 0, O_YS = 16777216, O_KVP0 = 16908288, O_KVP1 = 17039360, O_KVP2 = 17563648, O_CONVP = 19660800, O_KVS0 = 19676160, O_KVS1 = 19807232, O_KVS2 = 19938304, O_CONVS = 20069376, O_TOTAL = 22035456;
__device__ __forceinline__ float bf_lo(unsigned w) { return __uint_as_float(w << 16); }
__device__ __forceinline__ float bf_hi(unsigned w) { return __uint_as_float(w & 0xffff0000u); }
__device__ __forceinline__ float sigmoidf_(float x) { return __builtin_amdgcn_rcpf(1.0f + __expf(-x)); }
__device__ __forceinline__ f32x4 sigmoid4(f32x4 v) { f32x4 o; o[0] = sigmoidf_(v[0]); o[1] = sigmoidf_(v[1]); o[2] = sigmoidf_(v[2]); o[3] = sigmoidf_(v[3]); return o; }

struct EpiMain {
    static constexpr bool PERM = true, AFTER_DRAIN = false, HAS_MID = false;
    bf16_t* Z; const float* biasP; float* out;
    __device__ __forceinline__ void operator()(const f32x4 (&acc)[2][2][4][2], const Unit& u, int wr, int wc, int fr, int fq) const {
        const int pn = u.pn, rowb = u.pm * BM + wr * 64 + fr, cl = wc * 32 + 8 * fq;
        f32x4 bv[2][2];
#pragma unroll
        for (int bj = 0; bj < 2; ++bj)
#pragma unroll
            for (int n = 0; n < 2; ++n) bv[bj][n] = *(const f32x4*)(biasP + pn * BM + bj * HALF + cl + 4 * n);
        if (pn >= 20 && pn < 24) {
            const int cu = 128 * (pn - 20) + cl;
#pragma unroll
            for (int ai = 0; ai < 2; ++ai)
#pragma unroll
                for (int m = 0; m < 4; ++m) { const int row = rowb + ai * HALF + m * 16;
                    const f32x4 u0 = (acc[ai][0][m][0] + bv[0][0]) * sigmoid4(acc[ai][1][m][0] + bv[1][0]);
                    const f32x4 u1 = (acc[ai][0][m][1] + bv[0][1]) * sigmoid4(acc[ai][1][m][1] + bv[1][1]);
                    u32x4 w; w.x = cvt_pk_bf16(u0[0], u0[1]); w.y = cvt_pk_bf16(u0[2], u0[3]); w.z = cvt_pk_bf16(u1[0], u1[1]); w.w = cvt_pk_bf16(u1[2], u1[3]);
                    *(u32x4*)(Z + (size_t)row * ZP + ZU + cu) = w;
                    if (u.pm >= 63) {
                        if (row >= SEQ - 30 && row < SEQ) { float* o = out + O_CONVP + (size_t)(row - (SEQ - 30)) * 512 + cu; *(f32x4*)o = u0; *(f32x4*)(o + 4) = u1; }
                        else if (row >= SEQ && row < MROWS) { float* o = out + O_CONVS + ((size_t)(row - SEQ) * 30 + 29) * 512 + cu; *(f32x4*)o = u0; *(f32x4*)(o + 4) = u1; }
                    }
                }
            return;
        }
        const int zc0 = (pn < 20 ? pn * BM : pn * BM - 512) + cl;
#pragma unroll
        for (int ai = 0; ai < 2; ++ai)
#pragma unroll
            for (int m = 0; m < 4; ++m) { const int row = rowb + ai * HALF + m * 16; bf16_t* rowp = Z + (size_t)row * ZP + zc0;
#pragma unroll
                for (int bj = 0; bj < 2; ++bj) { f32x4 v0 = acc[ai][bj][m][0] + bv[bj][0], v1 = acc[ai][bj][m][1] + bv[bj][1];
                    if (pn < 6) { v0 = v0 * QSCALE; v1 = v1 * QSCALE; }
                    else if (pn < 18) {
                        if (u.pm >= 56) {
                            const int hh = (pn - 6) * 2 + bj, s = hh >= 12 ? 1 : 0, h12 = hh - 12 * s, gg = h12 >> 2, h4 = h12 & 3;
                            const int W = gg == 0 ? 128 : (gg == 1 ? 512 : 2048);
                            const size_t obp = gg == 0 ? O_KVP0 : (gg == 1 ? O_KVP1 : O_KVP2), obs = gg == 0 ? O_KVS0 : (gg == 1 ? O_KVS1 : O_KVS2);
                            if (row < SEQ) { const int tp = row - (SEQ - W);
                                if (tp >= 0) { float* o = out + obp + ((size_t)(tp * 2 + s) * 4 + h4) * 128 + cl; *(f32x4*)o = v0; *(f32x4*)(o + 4) = v1; } }
                            else if (row < MROWS) { float* o = out + obs + ((size_t)((row - SEQ) * 2 + s) * 4 + h4) * 128 + cl; *(f32x4*)o = v0; *(f32x4*)(o + 4) = v1; }
                        }
                    }
                    else if (pn < 26) { v0 = v0 * sigmoid4(v0); v1 = v1 * sigmoid4(v1); }
                    else { v0 = sigmoid4(v0); v1 = sigmoid4(v1); }
                    u32x4 w; w.x = cvt_pk_bf16(v0[0], v0[1]); w.y = cvt_pk_bf16(v0[2], v0[3]); w.z = cvt_pk_bf16(v1[0], v1[1]); w.w = cvt_pk_bf16(v1[2], v1[3]);
                    *(u32x4*)(rowp + bj * HALF) = w; } }
    }
};

struct EpiAB {
    static constexpr bool PERM = true, AFTER_DRAIN = false, HAS_MID = true;
    const bf16_t* Z; bf16_t* Mb;
    __device__ __forceinline__ void mid(f32x4 (&acc)[2][2][4][2], const Unit& u, int wr, int wc, int fr, int fq) const {
        int opq; asm volatile("v_mov_b32 %0, 0" : "=v"(opq));
        const int rowb = u.pm * BM + wr * 64 + fr + opq, col0 = u.pn * BM + wc * 32 + 8 * fq;
#pragma unroll
        for (int ai = 0; ai < 2; ++ai)
#pragma unroll
            for (int m = 0; m < 4; ++m) { const bf16_t* zr = Z + (size_t)(rowb + ai * HALF + m * 16) * ZP + col0;
#pragma unroll
                for (int bj = 0; bj < 2; ++bj) { const u32x4 a = *(const u32x4*)(zr + ZMA + bj * HALF), b = *(const u32x4*)(zr + ZMB + bj * HALF);
                    f32x4 r0, r1;
                    r0[0] = bf_lo(a.x) * __builtin_amdgcn_rcpf(fmaxf(bf_lo(b.x), 1e-30f)); r0[1] = bf_hi(a.x) * __builtin_amdgcn_rcpf(fmaxf(bf_hi(b.x), 1e-30f));
                    r0[2] = bf_lo(a.y) * __builtin_amdgcn_rcpf(fmaxf(bf_lo(b.y), 1e-30f)); r0[3] = bf_hi(a.y) * __builtin_amdgcn_rcpf(fmaxf(bf_hi(b.y), 1e-30f));
                    r1[0] = bf_lo(a.z) * __builtin_amdgcn_rcpf(fmaxf(bf_lo(b.z), 1e-30f)); r1[1] = bf_hi(a.z) * __builtin_amdgcn_rcpf(fmaxf(bf_hi(b.z), 1e-30f));
                    r1[2] = bf_lo(a.w) * __builtin_amdgcn_rcpf(fmaxf(bf_lo(b.w), 1e-30f)); r1[3] = bf_hi(a.w) * __builtin_amdgcn_rcpf(fmaxf(bf_hi(b.w), 1e-30f));
                    acc[ai][bj][m][0] *= r0; acc[ai][bj][m][1] *= r1; }
                asm volatile("" : "+v"(acc[ai][0][m][0]), "+v"(acc[ai][0][m][1]), "+v"(acc[ai][1][m][0]), "+v"(acc[ai][1][m][1]) :: "memory"); }
    }
    __device__ __forceinline__ void operator()(const f32x4 (&acc)[2][2][4][2], const Unit& u, int wr, int wc, int fr, int fq) const {
        const int rowb = u.pm * BM + wr * 64 + fr, col0 = u.pn * BM + wc * 32 + 8 * fq;
#pragma unroll
        for (int ai = 0; ai < 2; ++ai)
#pragma unroll
            for (int m = 0; m < 4; ++m) { const size_t row = (size_t)(rowb + ai * HALF + m * 16); const bf16_t* zr = Z + row * ZP + ZMB + col0;
#pragma unroll
                for (int bj = 0; bj < 2; ++bj) { const u32x4 b = *(const u32x4*)(zr + bj * HALF); const f32x4 v0 = acc[ai][bj][m][0], v1 = acc[ai][bj][m][1];
                    u32x4 w; w.x = cvt_pk_bf16(v0[0] * bf_lo(b.x), v0[1] * bf_hi(b.x)); w.y = cvt_pk_bf16(v0[2] * bf_lo(b.y), v0[3] * bf_hi(b.y));
                    w.z = cvt_pk_bf16(v1[0] * bf_lo(b.z), v1[1] * bf_hi(b.z)); w.w = cvt_pk_bf16(v1[2] * bf_lo(b.w), v1[3] * bf_hi(b.w));
                    *(u32x4*)(Mb + row * 1024 + col0 + bj * HALF) = w; } }
    }
};

struct EpiO {
    static constexpr bool PERM = false, AFTER_DRAIN = false, HAS_MID = false;
    const float* xp; const float* xs; const float* mod; float* out;
    __device__ __forceinline__ void operator()(const f32x4 (&acc)[2][2][4][2], const Unit& u, int wr, int wc, int fr, int fq) const {
        const int rowb = u.pm * BM + wr * 64 + fr, col0 = u.pn * BM + wc * 32 + 4 * fq;
        const float ALPHA = 1.189207115002721f;
#pragma unroll
        for (int ai = 0; ai < 2; ++ai)
#pragma unroll
            for (int m = 0; m < 4; ++m) { const int row = rowb + ai * HALF + m * 16;
                if (row < MROWS) {
                    const bool pr = row < SEQ; const int b = row - SEQ;
                    const float* xr = pr ? xp + (size_t)row * 1024 : xs + (size_t)b * 1024; const float* gr = mod + (pr ? 0 : (size_t)(1 + b) * 3072) + 2048;
                    float* orow = pr ? out + O_YP + (size_t)row * 1024 : out + O_YS + (size_t)b * 1024;
#pragma unroll
                    for (int bj = 0; bj < 2; ++bj)
#pragma unroll
                        for (int n = 0; n < 2; ++n) { const int c = col0 + bj * HALF + n * 16; const f32x4 xv = *(const f32x4*)(xr + c), gv = *(const f32x4*)(gr + c);
                            *(f32x4*)(orow + c) = xv * ALPHA + gv * acc[ai][bj][m][n]; }
                }
                asm volatile("" ::: "memory"); }
    }
};

template <class Epi, class Sched, bool ALIGN_EPI = false, bool SP2 = false>
__device__ __forceinline__ void gemm_phase(PG8_LAS unsigned char* lds, const Gemm g, const Sched& S, const Epi& E) {
    const int tid = threadIdx.x, wid = __builtin_amdgcn_readfirstlane(tid >> 6), lane = tid & 63, wr = wid >> 2, wc = wid & 3, fr = lane & 15, fq = lane >> 4;
    const int K = g.K, nt = K / BK;
    unsigned voffA[2], voffB[2];
#pragma unroll
    for (int i = 0; i < 2; ++i) { int R, C; stage_rc(tid * 16 + i * 8192, R, C); const int Rb = Epi::PERM ? ((R & ~31) + perm32(R & 31)) : R;
        voffA[i] = (unsigned)(R * K + C) * 2u; voffB[i] = (unsigned)(Rb * K + C) * 2u; }
    const size_t kstep = (size_t)(BK * 2);
    const size_t hstep = (size_t)HALF * K * 2;
    const size_t tstep = 2 * hstep;
    const unsigned ldsw = (unsigned)wid * 1024u;
    const int aoff = lds_byte(wr * 64 + fr, fq * 8), boff = lds_byte(wc * 32 + fr, fq * 8);
#define PG8_SA(b, h) (((b) * 2 + (h)) * HTB)
#define PG8_SB(b, h) ((4 + (b) * 2 + (h)) * HTB)
#define PG8_STAGE(bufoff, gbase, voff) do { _Pragma("unroll") for (int _i = 0; _i < 2; ++_i) \
        __builtin_amdgcn_global_load_lds((const unsigned*)((const char*)(gbase) + (voff)[_i]), (PG8_LAS unsigned*)(lds + (bufoff) + ldsw + _i * 8192), 16, 0, 0); } while (0)
#define PG8_LDA(dst, b, h) do { _Pragma("unroll") for (int m = 0; m < 4; ++m) _Pragma("unroll") for (int k = 0; k < 2; ++k) dst[m][k] = *(const PG8_LAS bf16x8*)(lds + PG8_SA(b, h) + aoff + m * 2048 + k * 1024); } while (0)
#define PG8_LDB(dst, b, h) do { _Pragma("unroll") for (int n = 0; n < 2; ++n) _Pragma("unroll") for (int k = 0; k < 2; ++k) dst[n][k] = *(const PG8_LAS bf16x8*)(lds + PG8_SB(b, h) + boff + n * 2048 + k * 1024); } while (0)
#define PG8_MMA(ai, bj, At, Bt) do { __builtin_amdgcn_s_setprio(1); _Pragma("unroll") for (int m = 0; m < 4; ++m) _Pragma("unroll") for (int n = 0; n < 2; ++n) _Pragma("unroll") for (int k = 0; k < 2; ++k) \
        acc[ai][bj][m][n] = __builtin_amdgcn_mfma_f32_16x16x32_bf16(Bt[n][k], At[m][k], acc[ai][bj][m][n], 0, 0, 0); __builtin_amdgcn_s_setprio(0); } while (0)
#define PG8_WAIT_V(n) asm volatile("s_waitcnt vmcnt(" #n ")" ::: "memory")
#define PG8_WAIT_L(n) asm volatile("s_waitcnt lgkmcnt(" #n ")" ::: "memory")
#define PG8_BAR __builtin_amdgcn_s_barrier()
#define PG8_SCHED __builtin_amdgcn_sched_barrier(0)
    Unit cur, nxt; int ui = 0;
    if (!S.next(0, cur)) return;
    f32x4 acc[2][2][4][2];
#pragma unroll
    for (int a = 0; a < 2; ++a)
#pragma unroll
        for (int b = 0; b < 2; ++b)
#pragma unroll
            for (int m = 0; m < 4; ++m)
#pragma unroll
                for (int n = 0; n < 2; ++n) acc[a][b][m][n] = (f32x4){0.f, 0.f, 0.f, 0.f};
    bf16x8 At[4][2], B0[2][2], B1[2][2];
    const char* cA = (const char*)g.A + (size_t)cur.pm * tstep; const char* cB = (const char*)g.Bt + (size_t)cur.pn * tstep;
    S.a_ready(cur);
    if constexpr (SP2) {
        PG8_STAGE(PG8_SB(0, 0), cB, voffB); PG8_STAGE(PG8_SB(0, 1), cB + hstep, voffB); PG8_STAGE(PG8_SA(0, 0), cA, voffA); PG8_STAGE(PG8_SA(0, 1), cA + hstep, voffA);
        if (wr == 1) PG8_BAR;
        PG8_WAIT_V(2); PG8_BAR;
        PG8_STAGE(PG8_SB(1, 0), cB + kstep, voffB); PG8_STAGE(PG8_SA(1, 0), cA + kstep, voffA); PG8_STAGE(PG8_SB(1, 1), cB + hstep + kstep, voffB);
        PG8_WAIT_V(6); PG8_BAR;
    } else {
        PG8_STAGE(PG8_SB(0, 0), cB, voffB); PG8_STAGE(PG8_SA(0, 0), cA, voffA); PG8_STAGE(PG8_SB(0, 1), cB + hstep, voffB); PG8_STAGE(PG8_SA(0, 1), cA + hstep, voffA);
        if (wr == 1) PG8_BAR;
        PG8_WAIT_V(4); PG8_BAR;
        PG8_STAGE(PG8_SB(1, 0), cB + kstep, voffB); PG8_STAGE(PG8_SA(1, 0), cA + kstep, voffA); PG8_STAGE(PG8_SB(1, 1), cB + hstep + kstep, voffB);
        PG8_WAIT_V(6); PG8_BAR;
    }
    for (;;) {
        const bool has_next = S.next(ui + 1, nxt);
        const char* nA = has_next ? (const char*)g.A + (size_t)nxt.pm * tstep : cA; const char* nB = has_next ? (const char*)g.Bt + (size_t)nxt.pn * tstep : cB;
        for (int t = 0; t < nt; t += 2) {
            const bool last = (t == nt - 2);
            const char* a1 = cA + (size_t)(t + 1) * kstep;
            const char* a2 = last ? nA : cA + (size_t)(t + 2) * kstep; const char* b2 = last ? nB : cB + (size_t)(t + 2) * kstep;
            const char* a3 = a2 + kstep; const char* b3 = b2 + kstep;
            if (last && has_next) S.a_ready(nxt);
            if constexpr (Epi::HAS_MID) { if (t == nt / 2) E.mid(acc, cur, wr, wc, fr, fq); }
            if constexpr (SP2) {
            PG8_LDB(B0, 0, 0); PG8_LDB(B1, 0, 1); PG8_SCHED; PG8_LDA(At, 0, 0); PG8_STAGE(PG8_SA(1, 1), a1 + hstep, voffA);
            PG8_WAIT_V(8); PG8_WAIT_L(0); PG8_BAR; PG8_MMA(0, 0, At, B0); PG8_MMA(0, 1, At, B1); PG8_BAR; PG8_SCHED;
            PG8_LDA(At, 0, 1); PG8_STAGE(PG8_SB(0, 0), b2, voffB); PG8_STAGE(PG8_SB(0, 1), b2 + hstep, voffB); PG8_STAGE(PG8_SA(0, 0), a2, voffA);
            PG8_WAIT_V(8); PG8_WAIT_L(0); PG8_BAR; PG8_MMA(1, 0, At, B0); PG8_MMA(1, 1, At, B1); PG8_BAR; PG8_SCHED;
            PG8_LDB(B0, 1, 0); PG8_LDB(B1, 1, 1); PG8_SCHED; PG8_LDA(At, 1, 0); PG8_STAGE(PG8_SA(0, 1), a2 + hstep, voffA);
            PG8_WAIT_V(8); PG8_WAIT_L(0); PG8_BAR; PG8_MMA(0, 0, At, B0); PG8_MMA(0, 1, At, B1); PG8_BAR; PG8_SCHED;
            PG8_LDA(At, 1, 1); PG8_STAGE(PG8_SB(1, 0), b3, voffB); PG8_STAGE(PG8_SB(1, 1), b3 + hstep, voffB); PG8_STAGE(PG8_SA(1, 0), a3, voffA);
            PG8_WAIT_V(8); PG8_WAIT_L(0); PG8_BAR; PG8_MMA(1, 0, At, B0); PG8_MMA(1, 1, At, B1); PG8_BAR; PG8_SCHED;
            } else {
            PG8_LDB(B0, 0, 0); PG8_SCHED; PG8_LDA(At, 0, 0); PG8_STAGE(PG8_SA(1, 1), a1 + hstep, voffA);
            PG8_WAIT_L(8); PG8_BAR; PG8_WAIT_L(0); PG8_MMA(0, 0, At, B0); PG8_BAR; PG8_SCHED;
            PG8_LDB(B1, 0, 1); PG8_STAGE(PG8_SB(0, 0), b2, voffB);
            PG8_BAR; PG8_WAIT_L(0); PG8_MMA(0, 1, At, B1); PG8_BAR;
            PG8_LDA(At, 0, 1); PG8_STAGE(PG8_SA(0, 0), a2, voffA);
            PG8_BAR; PG8_WAIT_L(0); PG8_MMA(1, 0, At, B0); PG8_BAR; PG8_SCHED;
            PG8_STAGE(PG8_SB(0, 1), b2 + hstep, voffB);
            PG8_WAIT_V(6); PG8_BAR; PG8_MMA(1, 1, At, B1); PG8_BAR;
            PG8_LDB(B0, 1, 0); PG8_SCHED; PG8_LDA(At, 1, 0); PG8_STAGE(PG8_SA(0, 1), a2 + hstep, voffA);
            PG8_WAIT_L(8); PG8_BAR; PG8_WAIT_L(0); PG8_MMA(0, 0, At, B0); PG8_BAR; PG8_SCHED;
            PG8_LDB(B1, 1, 1); PG8_STAGE(PG8_SB(1, 0), b3, voffB);
            PG8_BAR; PG8_WAIT_L(0); PG8_MMA(0, 1, At, B1); PG8_BAR;
            PG8_LDA(At, 1, 1); PG8_STAGE(PG8_SA(1, 0), a3, voffA);
            PG8_BAR; PG8_WAIT_L(0); PG8_MMA(1, 0, At, B0); PG8_BAR; PG8_SCHED;
            PG8_STAGE(PG8_SB(1, 1), b3 + hstep, voffB);
            PG8_WAIT_V(6); PG8_BAR; PG8_MMA(1, 1, At, B1); PG8_BAR;
            }
        }
        if constexpr (ALIGN_EPI) { if (wr == 0) PG8_BAR; }
        if constexpr (!Epi::AFTER_DRAIN) { E(acc, cur, wr, wc, fr, fq); S.done(cur); }
        if (!has_next) break;
#pragma unroll
        for (int a = 0; a < 2; ++a)
#pragma unroll
            for (int b = 0; b < 2; ++b)
#pragma unroll
                for (int m = 0; m < 4; ++m)
#pragma unroll
                    for (int n = 0; n < 2; ++n) acc[a][b][m][n] = (f32x4){0.f, 0.f, 0.f, 0.f};
        cur = nxt; cA = nA; cB = nB; ++ui;
        if constexpr (ALIGN_EPI) { if (wr == 1) PG8_BAR; }
    }
    PG8_WAIT_V(0);
    if constexpr (!ALIGN_EPI) { if (wr == 0) PG8_BAR; }
    PG8_BAR;
    if constexpr (Epi::AFTER_DRAIN) { E.fused(acc, cur, wr, wc, fr, fq, lds, wid, lane); S.done(cur); }
#undef PG8_SA
#undef PG8_SB
#undef PG8_STAGE
#undef PG8_LDA
#undef PG8_LDB
#undef PG8_MMA
#undef PG8_WAIT_V
#undef PG8_WAIT_L
#undef PG8_BAR
#undef PG8_SCHED
}
}
namespace att {
#define ALAS __attribute__((address_space(3)))
typedef unsigned short bf16_t;
typedef short bf16x8 __attribute__((ext_vector_type(8)));
typedef short s16x4 __attribute__((ext_vector_type(4)));
typedef float f32x16 __attribute__((ext_vector_type(16)));
typedef float f32x4 __attribute__((ext_vector_type(4)));
typedef unsigned u32x4 __attribute__((ext_vector_type(4)));
constexpr int TILE_B = 16384;
constexpr int V_OFF = 0, K_OFF = 2 * TILE_B, SCR_OFF = 4 * TILE_B, ATT_LDS = SCR_OFF + 8 * 256;
#define KSWZ(row, colB) ((row) * 256 + ((colB) ^ (((row) & 7) << 4)))
__device__ __forceinline__ int crow(int r, int hi) { return (r & 3) + 8 * (r >> 2) + 4 * hi; }
__device__ __forceinline__ unsigned cvtpk(float lo, float hi) { unsigned r; asm volatile("v_cvt_pk_bf16_f32 %0, %1, %2" : "=v"(r) : "v"(lo), "v"(hi)); return r; }
__device__ __forceinline__ int v_st(int k, int c) { const int kk = (k & ~0xC) | ((k & 4) << 1) | ((k & 8) >> 1); return ((kk >> 3) * 4 + (c >> 5)) * 512 + ((kk & 7) * 32 + (c & 31)) * 2; }
__device__ __forceinline__ int v_rd_base(int lane) { return ((lane & 3) << 3) | (((lane >> 2) & 3) << 6) | (((lane >> 4) & 1) << 5) | (((lane >> 5) & 1) << 8); }
constexpr int v_rd_off(int d0, int ks, int half) { return d0 * 512 + ks * 4096 + half * 2048; }
template <int OFF> __device__ __forceinline__ s16x4 tr_read(int vb) { s16x4 r; asm volatile("ds_read_b64_tr_b16 %0, %1 offset:%2" : "=&v"(r) : "v"(vb), "i"(OFF) : "memory"); return r; }
template <int D0> __device__ __forceinline__ void pv_one(f32x16& od, int vb, bf16x8 pa0, bf16x8 pa1, bf16x8 pa2, bf16x8 pa3) {
    const s16x4 l0 = tr_read<v_rd_off(D0, 0, 0)>(vb), h0 = tr_read<v_rd_off(D0, 0, 1)>(vb), l1 = tr_read<v_rd_off(D0, 1, 0)>(vb), h1 = tr_read<v_rd_off(D0, 1, 1)>(vb);
    const s16x4 l2 = tr_read<v_rd_off(D0, 2, 0)>(vb), h2 = tr_read<v_rd_off(D0, 2, 1)>(vb), l3 = tr_read<v_rd_off(D0, 3, 0)>(vb), h3 = tr_read<v_rd_off(D0, 3, 1)>(vb);
    asm volatile("s_waitcnt lgkmcnt(0)" ::: "memory"); __builtin_amdgcn_sched_barrier(0);
#define ATT_PK(L, H) (bf16x8){L[0], L[1], L[2], L[3], H[0], H[1], H[2], H[3]}
    od = __builtin_amdgcn_mfma_f32_32x32x16_bf16(pa0, ATT_PK(l0, h0), od, 0, 0, 0);
    od = __builtin_amdgcn_mfma_f32_32x32x16_bf16(pa1, ATT_PK(l1, h1), od, 0, 0, 0);
    od = __builtin_amdgcn_mfma_f32_32x32x16_bf16(pa2, ATT_PK(l2, h2), od, 0, 0, 0);
    od = __builtin_amdgcn_mfma_f32_32x32x16_bf16(pa3, ATT_PK(l3, h3), od, 0, 0, 0);
#undef ATT_PK
}
__device__ __forceinline__ void prompt_unit(ALAS unsigned char* lds, const bf16_t* __restrict__ Z, bf16_t* __restrict__ OG, float* __restrict__ LSE, int unit) {
    const int tid = threadIdx.x, wid = __builtin_amdgcn_readfirstlane(tid >> 6), lane = tid & 63, r32 = lane & 31, hi = lane >> 5;
    const int hd = unit >> 6, sub = unit & 63, g = hd >> 2, j = hd & 3;
    const int dsh = 2 * g, d = 1 << dsh;
    const int nbq = 64 >> dsh, rcls = sub / nbq, bq = sub - rcls * nbq, i0 = bq * 256;
    const float sl2 = __builtin_amdgcn_exp2f(-(8.0f / 12.0f) * (float)(hd + 1)) * (float)d * 1.4426950408889634f;
    const bf16_t* Zc = Z + (size_t)rcls * 8192 + hd * 128;
    const size_t rstep = (size_t)d * 8192;
    ALAS float* scr = (ALAS float*)(lds + SCR_OFF + wid * 256);
    bf16x8 qr[8];
    { const bf16_t* Qw = Zc + (size_t)(i0 + wid * 32 + r32) * rstep + hi * 8;
#pragma unroll
      for (int d0 = 0; d0 < 8; ++d0) qr[d0] = *(const bf16x8*)(Qw + d0 * 16); }
    const int sr = tid >> 4, sc = (tid & 15) * 8, vst0 = v_st(sr, sc), vst1 = v_st(32 + sr, sc), kst0 = KSWZ(sr, sc * 2), kst1 = KSWZ(32 + sr, sc * 2);
    const int vb0 = (int)(unsigned)(uintptr_t)(lds + V_OFF) + v_rd_base(lane);
    float m_reg = -1e30f, l_reg = 0.f; f32x16 o[4];
#pragma unroll
    for (int q = 0; q < 4; ++q)
#pragma unroll
        for (int r = 0; r < 16; ++r) o[q][r] = 0.f;
    const int t_first = (bq == 0) ? 2 : 0;
    bf16x8 ks0, ks1, vs0, vs1;
#define ATT_SLOAD(t) do { const bf16_t* kp = Zc + (size_t)(i0 - 128 + 64 * (t) + sr) * rstep + sc; \
        ks0 = *(const bf16x8*)(kp + 1536); ks1 = *(const bf16x8*)(kp + 32 * rstep + 1536); vs0 = *(const bf16x8*)(kp + 3072); vs1 = *(const bf16x8*)(kp + 32 * rstep + 3072); } while (0)
#define ATT_SWRITE(b) do { *(ALAS bf16x8*)(lds + V_OFF + (b) * TILE_B + vst0) = vs0; *(ALAS bf16x8*)(lds + V_OFF + (b) * TILE_B + vst1) = vs1; \
        *(ALAS bf16x8*)(lds + K_OFF + (b) * TILE_B + kst0) = ks0; *(ALAS bf16x8*)(lds + K_OFF + (b) * TILE_B + kst1) = ks1; } while (0)
    ATT_SLOAD(t_first); ATT_SWRITE(t_first & 1); __syncthreads();
    for (int t = t_first; t < 6; ++t) {
        const int b = t & 1;
        if (t + 1 < 6) ATT_SLOAD(t + 1);
        const int tw = t - (wid >> 1);
        if (tw >= 0 && tw <= 2) {
            f32x16 p0, p1;
#pragma unroll
            for (int r = 0; r < 16; ++r) { p0[r] = 0.f; p1[r] = 0.f; }
            const ALAS unsigned char* Kb = lds + K_OFF + b * TILE_B;
#pragma unroll
            for (int d0 = 0; d0 < 8; ++d0) { const int cb = (d0 * 16 + hi * 8) * 2;
                const bf16x8 b0 = *(const ALAS bf16x8*)(Kb + KSWZ(r32, cb)), b1 = *(const ALAS bf16x8*)(Kb + KSWZ(32 + r32, cb));
                p0 = __builtin_amdgcn_mfma_f32_32x32x16_bf16(b0, qr[d0], p0, 0, 0, 0);
                p1 = __builtin_amdgcn_mfma_f32_32x32x16_bf16(b1, qr[d0], p1, 0, 0, 0); }
            const int dbase = 32 * wid + r32 + 128 - 64 * t;
            float pmax = -1e30f;
#pragma unroll
            for (int r = 0; r < 16; ++r) { const int d0 = dbase - crow(r, hi), d1 = d0 - 32;
                p0[r] = ((unsigned)d0 <= 128u) ? p0[r] - sl2 * (float)d0 : -1e30f; p1[r] = ((unsigned)d1 <= 128u) ? p1[r] - sl2 * (float)d1 : -1e30f;
                pmax = fmaxf(pmax, fmaxf(p0[r], p1[r])); }
            { auto rr = __builtin_amdgcn_permlane32_swap(__float_as_uint(pmax), __float_as_uint(pmax), false, false); pmax = fmaxf(__uint_as_float(rr[0]), __uint_as_float(rr[1])); }
            const float mn = fmaxf(m_reg, pmax), alpha = __builtin_amdgcn_exp2f(m_reg - mn); m_reg = mn;
            float ps = 0.f;
#pragma unroll
            for (int r = 0; r < 16; ++r) { const float e0 = __builtin_amdgcn_exp2f(p0[r] - mn), e1 = __builtin_amdgcn_exp2f(p1[r] - mn);
                p0[r] = (p0[r] > -1e29f) ? e0 : 0.f; p1[r] = (p1[r] > -1e29f) ? e1 : 0.f; ps += p0[r] + p1[r]; }
            { auto rr = __builtin_amdgcn_permlane32_swap(__float_as_uint(ps), __float_as_uint(ps), false, false); ps = __uint_as_float(rr[0]) + __uint_as_float(rr[1]); }
            l_reg = l_reg * alpha + ps;
            if (hi == 0) scr[r32] = alpha;
            asm volatile("s_waitcnt lgkmcnt(0)" ::: "memory");
#pragma unroll
            for (int r = 0; r < 16; ++r) { const float a = scr[crow(r, hi)];
#pragma unroll
                for (int q = 0; q < 4; ++q) o[q][r] *= a; }
            bf16x8 pa0, pa1, pa2, pa3;
#define ATT_PK4(P, BASE, OUT) do { unsigned a0 = cvtpk(P[BASE + 0], P[BASE + 1]), a1 = cvtpk(P[BASE + 2], P[BASE + 3]); \
        unsigned b0_ = cvtpk(P[BASE + 4], P[BASE + 5]), b1_ = cvtpk(P[BASE + 6], P[BASE + 7]); \
        auto r0 = __builtin_amdgcn_permlane32_swap(a0, b0_, false, false); auto r1 = __builtin_amdgcn_permlane32_swap(a1, b1_, false, false); \
        u32x4 w_ = {r0[0], r1[0], r0[1], r1[1]}; OUT = *reinterpret_cast<bf16x8*>(&w_); } while (0)
            ATT_PK4(p0, 0, pa0); ATT_PK4(p0, 8, pa1); ATT_PK4(p1, 0, pa2); ATT_PK4(p1, 8, pa3);
#undef ATT_PK4
            const int vb = vb0 + b * TILE_B;
            pv_one<0>(o[0], vb, pa0, pa1, pa2, pa3); pv_one<1>(o[1], vb, pa0, pa1, pa2, pa3); pv_one<2>(o[2], vb, pa0, pa1, pa2, pa3); pv_one<3>(o[3], vb, pa0, pa1, pa2, pa3);
        }
        if (t + 1 < 6) { ATT_SWRITE(b ^ 1); }
        __syncthreads();
    }
#undef ATT_SLOAD
#undef ATT_SWRITE
    if (hi == 0) scr[r32] = __builtin_amdgcn_rcpf(l_reg);
    asm volatile("s_waitcnt lgkmcnt(0)" ::: "memory");
    const size_t orow0 = (size_t)rcls + (size_t)(i0 + wid * 32) * d;
    bf16_t* Og = OG + (size_t)g * pg8::MPAD * 512 + j * 128 + r32;
#pragma unroll
    for (int r = 0; r < 16; ++r) { const int qrow = crow(r, hi); const float rl = scr[qrow]; bf16_t* op = Og + (orow0 + (size_t)qrow * d) * 512;
#pragma unroll
        for (int q = 0; q < 4; ++q) { const unsigned w = cvtpk(o[q][r] * rl, 0.f); op[q * 32] = (bf16_t)(w & 0xffffu); } }
    if (hi == 0) LSE[((size_t)g * pg8::MPAD + orow0 + (size_t)r32 * d) * 4 + j] = m_reg + __builtin_amdgcn_logf(l_reg);
    asm volatile("s_waitcnt lgkmcnt(0)" ::: "memory");
    __syncthreads();
}

__device__ __forceinline__ void sample_unit(const bf16_t* __restrict__ Z, const float* __restrict__ cache, int Wb, bf16_t* __restrict__ OG, float* __restrict__ LSE, int b, int g, int h, int lane) {
    const int hd = g * 4 + h, d = 1 << (2 * g), sub = lane & 15, grp = lane >> 4;
    const float sl2 = __builtin_amdgcn_exp2f(-(8.0f / 12.0f) * (float)(hd + 1)) * (float)d * 1.4426950408889634f;
    const bf16_t* zrow = Z + (size_t)(pg8::SEQ + b) * 8192 + hd * 128 + sub * 8;
    float q[8], kn[8], vn[8];
    { const u32x4 qa = *(const u32x4*)zrow, ka = *(const u32x4*)(zrow + 1536), va = *(const u32x4*)(zrow + 3072);
      q[0] = pg8::bf_lo(qa.x); q[1] = pg8::bf_hi(qa.x); q[2] = pg8::bf_lo(qa.y); q[3] = pg8::bf_hi(qa.y); q[4] = pg8::bf_lo(qa.z); q[5] = pg8::bf_hi(qa.z); q[6] = pg8::bf_lo(qa.w); q[7] = pg8::bf_hi(qa.w);
      kn[0] = pg8::bf_lo(ka.x); kn[1] = pg8::bf_hi(ka.x); kn[2] = pg8::bf_lo(ka.y); kn[3] = pg8::bf_hi(ka.y); kn[4] = pg8::bf_lo(ka.z); kn[5] = pg8::bf_hi(ka.z); kn[6] = pg8::bf_lo(ka.w); kn[7] = pg8::bf_hi(ka.w);
      vn[0] = pg8::bf_lo(va.x); vn[1] = pg8::bf_hi(va.x); vn[2] = pg8::bf_lo(va.y); vn[3] = pg8::bf_hi(va.y); vn[4] = pg8::bf_lo(va.z); vn[5] = pg8::bf_hi(va.z); vn[6] = pg8::bf_lo(va.w); vn[7] = pg8::bf_hi(va.w); }
    const float* cb = cache + (size_t)b * Wb * 1024 + h * 128 + sub * 8 + (size_t)grp * d * 1024;
    const size_t cstep = (size_t)4 * d * 1024;
    float sc[32];
#pragma unroll
    for (int i0 = 0; i0 < 32; i0 += 8) {
        f32x4 ka[8], kb[8];
#pragma unroll
        for (int i = 0; i < 8; ++i) { const float* p = cb + (size_t)(i0 + i) * cstep; ka[i] = __builtin_nontemporal_load((const f32x4*)p); kb[i] = __builtin_nontemporal_load((const f32x4*)(p + 4)); }
#pragma unroll
        for (int i = 0; i < 8; ++i) { float s = q[0] * ka[i][0] + q[1] * ka[i][1] + q[2] * ka[i][2] + q[3] * ka[i][3] + q[4] * kb[i][0] + q[5] * kb[i][1] + q[6] * kb[i][2] + q[7] * kb[i][3];
            s += __shfl_xor(s, 1); s += __shfl_xor(s, 2); s += __shfl_xor(s, 4); s += __shfl_xor(s, 8);
            sc[i0 + i] = s - sl2 * (float)(128 - (4 * (i0 + i) + grp)); }
    }
    float sn = q[0] * kn[0] + q[1] * kn[1] + q[2] * kn[2] + q[3] * kn[3] + q[4] * kn[4] + q[5] * kn[5] + q[6] * kn[6] + q[7] * kn[7];
    sn += __shfl_xor(sn, 1); sn += __shfl_xor(sn, 2); sn += __shfl_xor(sn, 4); sn += __shfl_xor(sn, 8);
    float mx = sn;
#pragma unroll
    for (int i = 0; i < 32; ++i) mx = fmaxf(mx, sc[i]);
    mx = fmaxf(mx, __shfl_xor(mx, 16)); mx = fmaxf(mx, __shfl_xor(mx, 32));
    float l = 0.f;
#pragma unroll
    for (int i = 0; i < 32; ++i) { sc[i] = __builtin_amdgcn_exp2f(sc[i] - mx); l += sc[i]; }
    l += __shfl_xor(l, 16); l += __shfl_xor(l, 32);
    const float pn = __builtin_amdgcn_exp2f(sn - mx); l += pn;
    float acc[8];
#pragma unroll
    for (int e = 0; e < 8; ++e) acc[e] = 0.f;
#pragma unroll
    for (int i0 = 0; i0 < 32; i0 += 8) {
        f32x4 va[8], vb[8];
#pragma unroll
        for (int i = 0; i < 8; ++i) { const float* p = cb + (size_t)(i0 + i) * cstep + 512; va[i] = __builtin_nontemporal_load((const f32x4*)p); vb[i] = __builtin_nontemporal_load((const f32x4*)(p + 4)); }
#pragma unroll
        for (int i = 0; i < 8; ++i) { const float p = sc[i0 + i];
            acc[0] += p * va[i][0]; acc[1] += p * va[i][1]; acc[2] += p * va[i][2]; acc[3] += p * va[i][3]; acc[4] += p * vb[i][0]; acc[5] += p * vb[i][1]; acc[6] += p * vb[i][2]; acc[7] += p * vb[i][3]; }
    }
    const float rl = __builtin_amdgcn_rcpf(l);
#pragma unroll
    for (int e = 0; e < 8; ++e) { float a = acc[e]; a += __shfl_xor(a, 16); a += __shfl_xor(a, 32); acc[e] = (a + pn * vn[e]) * rl; }
    if (grp == 0) { u32x4 w; w.x = cvtpk(acc[0], acc[1]); w.y = cvtpk(acc[2], acc[3]); w.z = cvtpk(acc[4], acc[5]); w.w = cvtpk(acc[6], acc[7]);
        *(u32x4*)(OG + ((size_t)g * pg8::MPAD + pg8::SEQ + b) * 512 + h * 128 + sub * 8) = w; }
    if (lane == 0) LSE[((size_t)g * pg8::MPAD + pg8::SEQ + b) * 4 + h] = mx + __builtin_amdgcn_logf(l);
}
}

constexpr int NWAVES = 8;
#ifndef MK_N_LAUNCHES
#define MK_N_LAUNCHES 8
#endif
constexpr int NPHASE = 8;
constexpr int N_LAUNCHES = MK_N_LAUNCHES;
static_assert(N_LAUNCHES == 1 || N_LAUNCHES == NPHASE, "MK_N_LAUNCHES is 1 or 8");

constexpr size_t MiB = 1u << 20;
constexpr size_t WS_CTL = 0, CTL_ZERO_BYTES = 1 * MiB;
constexpr size_t WS_MOD = 1 * MiB;
constexpr size_t WS_BIASP = 3 * MiB;
constexpr size_t WS_WIN = 4 * MiB;
constexpr size_t WS_WAB = 21 * MiB;
constexpr size_t WS_WO = 23 * MiB;
constexpr size_t WS_LSE = 25 * MiB;
constexpr size_t WS_H = 32 * MiB;
constexpr size_t WS_A12 = 65 * MiB;
constexpr size_t WS_MB = 98 * MiB;
constexpr size_t WS_OG = 131 * MiB;
constexpr size_t WS_Z = 192 * MiB;
constexpr size_t WS_END = 452 * MiB;
constexpr int CW_BAR = 4096;

constexpr int RING_BYTES = 131072, LDSCTL_OFF = RING_BYTES, MISC_OFF = LDSCTL_OFF + 320, LDS_BYTES = 147456;

#define GAS __attribute__((address_space(1)))
#define LAS __attribute__((address_space(3)))
typedef unsigned short bf16;
typedef unsigned v4u __attribute__((ext_vector_type(4)));
typedef float f32x4 __attribute__((ext_vector_type(4)));
#define LDS_WAIT() asm volatile("s_waitcnt lgkmcnt(0)" ::: "memory")
__device__ __forceinline__ unsigned f2bf(float f) { unsigned u = __builtin_bit_cast(unsigned, f); return (u + 0x7fffu + ((u >> 16) & 1u)) >> 16; }
__device__ __forceinline__ unsigned pk2(float lo, float hi) { return f2bf(lo) | (f2bf(hi) << 16); }
__device__ __forceinline__ float wave_sum(float v) {
#pragma unroll
    for (int o = 1; o < 64; o <<= 1) v += __shfl_xor(v, o);
    return v;
}

#define XB_TMO      128
#define XB_XCNT(j)  (256  + 64 * (j))
#define XB_XSUB(j)  (1280 + 64 * (j))
#define XB_XGEN(j)  (2304 + 64 * (j))
#define XB_TOP      3328
#define XB_TOPGEN   3392
#define XCD_BAR_WORDS 3456
#define XB_SPIN_CAP (1u << 18)

__device__ __forceinline__ unsigned xb_ld(unsigned* p)              { return __hip_atomic_load(p, __ATOMIC_RELAXED, __HIP_MEMORY_SCOPE_AGENT); }
__device__ __forceinline__ unsigned xb_add(unsigned* p, unsigned v) { return __hip_atomic_fetch_add(p, v, __ATOMIC_RELAXED, __HIP_MEMORY_SCOPE_AGENT); }
__device__ __forceinline__ unsigned xb_xcc_id() { return (unsigned)__builtin_amdgcn_s_getreg((3 << 11) | 20) & 0xFu; }
#define XB_SPIN(cond, bar) do { unsigned _sp = 0; while (cond) { __builtin_amdgcn_s_sleep(1); \
    if ((++_sp & 255u) == 0u) { if (xb_ld(&(bar)[XB_TMO])) break; if (_sp > XB_SPIN_CAP) { atomicAdd(&(bar)[XB_TMO], 1u); break; } } } } while (0)

struct XcdBarrier {
    unsigned* bar; unsigned x;
    volatile LAS unsigned* st;
};

__device__ __forceinline__ XcdBarrier xcd_barrier_post(unsigned* bar, volatile LAS unsigned* st) {
    XcdBarrier b; b.bar = bar; b.x = xb_xcc_id(); b.st = st;
    if (threadIdx.x == 0) (void)xb_add(&bar[XB_XCNT(b.x)], 1u);
    return b;
}
__device__ __forceinline__ void xcd_barrier_complete(unsigned* bar, unsigned x, unsigned& nloc, unsigned& nx) {
    const unsigned G = gridDim.x * gridDim.y * gridDim.z;
    unsigned sum, cnt, mine, sp = 0u;
    for (;;) {
        sum = 0u; cnt = 0u; mine = 0u;
#pragma unroll
        for (unsigned j = 0; j < 16; ++j) { const unsigned c = xb_ld(&bar[XB_XCNT(j)]); sum += c; cnt += (c > 0u) ? 1u : 0u; mine = (j == x) ? c : mine; }
        if (sum == G) break;
        __builtin_amdgcn_s_sleep(1);
        if ((++sp & 255u) == 0u) { if (xb_ld(&bar[XB_TMO])) break; if (sp > XB_SPIN_CAP) { atomicAdd(&bar[XB_TMO], 1u); break; } }
    }
    nloc = mine > 0u ? mine : 1u; nx = cnt > 0u ? cnt : 1u;
}

__device__ __forceinline__ void xcd_barrier(const XcdBarrier& b) {
    asm volatile("s_waitcnt vmcnt(0)" ::: "memory");
    __syncthreads();
    if (threadIdx.x == 0) {
        unsigned* bar = b.bar;
        __builtin_amdgcn_s_waitcnt(0);
        unsigned nloc = b.st[0], nx = b.st[1];
        if (nloc == 0u) { xcd_barrier_complete(bar, b.x, nloc, nx); b.st[0] = nloc; b.st[1] = nx; }
        const unsigned old = xb_add(&bar[XB_XSUB(b.x)], 1u);
        const unsigned gen = old / nloc;
        if (old + 1u == (gen + 1u) * nloc) {
            __builtin_amdgcn_fence(__ATOMIC_RELEASE, "agent");
            asm volatile("s_waitcnt vmcnt(0)" ::: "memory");
            const unsigned og = xb_add(&bar[XB_TOP], 1u);
            const unsigned tg = og / nx;
            if (og + 1u == (tg + 1u) * nx) xb_add(&bar[XB_TOPGEN], 1u);
            else XB_SPIN(xb_ld(&bar[XB_TOPGEN]) == tg, bar);
            __builtin_amdgcn_fence(__ATOMIC_ACQUIRE, "agent");
            xb_add(&bar[XB_XGEN(b.x)], 1u);
            asm volatile("s_waitcnt vmcnt(0)" ::: "memory");
        } else {
            XB_SPIN(xb_ld(&bar[XB_XGEN(b.x)]) == gen, bar);
            __builtin_amdgcn_fence(__ATOMIC_ACQUIRE, "agent");
            asm volatile("s_waitcnt vmcnt(0)" ::: "memory");
        }
    }
    __syncthreads();
}


__device__ __forceinline__ void transpose_item(const float* W, int N, bf16* WT, int ldt, int koff, int drow0, int k0, int n0, LAS float* scr, int lane) {
#pragma unroll 8
    for (int i = 0; i < 32; ++i) { const int kk = 2 * i + (lane >> 5); scr[kk * 33 + (lane & 31)] = W[(size_t)(k0 + kk) * N + n0 + (lane & 31)]; }
    LDS_WAIT(); asm volatile("" ::: "memory");
    const int c = lane & 7;
#pragma unroll
    for (int j = 0; j < 4; ++j) { const int n = (lane >> 3) + 8 * j; const LAS float* s = scr + (8 * c) * 33 + n;
        v4u o; o.x = pk2(s[0 * 33], s[1 * 33]); o.y = pk2(s[2 * 33], s[3 * 33]); o.z = pk2(s[4 * 33], s[5 * 33]); o.w = pk2(s[6 * 33], s[7 * 33]);
        *(v4u*)(WT + (size_t)(drow0 + n) * ldt + koff + k0 + 8 * c) = o; }
    LDS_WAIT(); asm volatile("" ::: "memory");
}
__device__ __forceinline__ int win_dst_col(int n) { if (n < 5120 || n >= 6144) return n; const int c = n - 5120, h = c >> 9, t = (c & 511) >> 7, jj = c & 127; return 5120 + t * 256 + h * 128 + jj; }

struct Args { const float* in[21]; float* out; unsigned char* ws; int ph_lo, ph_hi; };
static_assert(sizeof(Args) == 21 * 8 + 8 + 8 + 8, "Args has no padding");

__global__ void __launch_bounds__(NWAVES * 64, 2) fwd_kernel(Args args) {
    extern __shared__ __attribute__((aligned(16))) unsigned char lds_raw[];
    LAS unsigned char* lds = (LAS unsigned char*)lds_raw;
    volatile LAS unsigned* MISC = (volatile LAS unsigned*)(lds + MISC_OFF);
    const int tid = threadIdx.x, lane = tid & 63, wave = __builtin_amdgcn_readfirstlane(tid >> 6);
    const int G = gridDim.x, blk = blockIdx.x;
    unsigned char* ws = args.ws;
    unsigned* ctl = (unsigned*)(ws + WS_CTL);
    const float* x_p = args.in[0]; const float* x_s = args.in[1]; const float* c_p = args.in[2]; const float* c_s = args.in[3];
    const float* cache0 = args.in[4]; const float* cache1 = args.in[5]; const float* cache2 = args.in[6]; const float* st_conv = args.in[7];
    const float* w_c = args.in[8]; const float* b_c = args.in[9]; const float* w_in = args.in[10]; const float* b_in = args.in[11];
    const float* conv_w = args.in[12]; const float* conv_b = args.in[13]; const float* cn_g = args.in[14]; const float* cn_b = args.in[15];
    const float* w_pa = args.in[16]; const float* w_pb = args.in[17]; const float* w_o = args.in[18]; const float* ln_g = args.in[19]; const float* ln_b = args.in[20];
    float* out = args.out;
    float* MOD = (float*)(ws + WS_MOD); float* BIASP = (float*)(ws + WS_BIASP); float* LSE = (float*)(ws + WS_LSE);
    bf16* WIN = (bf16*)(ws + WS_WIN); bf16* WAB = (bf16*)(ws + WS_WAB); bf16* WO = (bf16*)(ws + WS_WO);
    bf16* H = (bf16*)(ws + WS_H); bf16* A12 = (bf16*)(ws + WS_A12); bf16* MB = (bf16*)(ws + WS_MB); bf16* OG = (bf16*)(ws + WS_OG); bf16* Z = (bf16*)(ws + WS_Z);

    for (int u = tid; u < (LDS_BYTES - LDSCTL_OFF) / 4; u += NWAVES * 64) ((LAS unsigned*)(lds + LDSCTL_OFF))[u] = 0u;
    __syncthreads();
    XcdBarrier bar; bar.bar = ctl + CW_BAR; bar.x = 0; bar.st = nullptr;
    if (N_LAUNCHES == 1) bar = xcd_barrier_post(ctl + CW_BAR, MISC + 8);
#define GRID_BAR() do { if (N_LAUNCHES == 1) xcd_barrier(bar); } while (0)
    const int lo = args.ph_lo, hi = args.ph_hi;
#ifndef PH_MASK
#define PH_MASK 0xff
#endif
#define IN(k) (((PH_MASK >> (k)) & 1) && lo <= (k) && (k) < hi)
#define BOTH(k) (IN(k) && IN((k) + 1))
    const int gw = blk * NWAVES + wave, NGW = G * NWAVES;

    if (IN(0)) {
        {
            LAS float* red = (LAS float*)lds;
            for (int cg = blk; cg < 256; cg += G) {
                const int n0 = cg * 12;
                float a0[12], a1[12], a2[12];
#pragma unroll
                for (int n = 0; n < 12; ++n) { a0[n] = 0.f; a1[n] = 0.f; a2[n] = 0.f; }
                const float* c0 = (lane == 0) ? c_p : c_s + (size_t)(lane - 1) * 1024;
                const float* c1 = c_s + (size_t)(lane + 63) * 1024;
                const float* c2 = c_s + (size_t)127 * 1024;
                const int kb = wave * 128;
                for (int k = kb; k < kb + 128; k += 4) {
                    const f32x4 v0 = *(const f32x4*)(c0 + k), v1 = *(const f32x4*)(c1 + k), v2 = *(const f32x4*)(c2 + k);
#pragma unroll
                    for (int kk = 0; kk < 4; ++kk) { const float* wr = w_c + (size_t)(k + kk) * 3072 + n0;
#pragma unroll
                        for (int n = 0; n < 12; ++n) { const float w = wr[n]; a0[n] += v0[kk] * w; a1[n] += v1[kk] * w; a2[n] += v2[kk] * w; } }
                }
#pragma unroll
                for (int n = 0; n < 12; ++n) { red[(wave * 129 + lane) * 12 + n] = a0[n]; red[(wave * 129 + lane + 64) * 12 + n] = a1[n]; if (lane == 0) red[(wave * 129 + 128) * 12 + n] = a2[n]; }
                __syncthreads();
                for (int idx = tid; idx < 129 * 12; idx += NWAVES * 64) { const int rho = idx / 12, n = idx - rho * 12; float s = 0.f;
#pragma unroll
                    for (int w = 0; w < 8; ++w) s += red[(w * 129 + rho) * 12 + n];
                    MOD[(size_t)rho * 3072 + n0 + n] = s + b_c[n0 + n]; }
                __syncthreads();
            }
        }
        {
            LAS float* scr = (LAS float*)(lds + wave * 16384);
            constexpr int I_IN = 16 * 272, I_PA = 8 * 32, I_PB = 8 * 32, I_O = 16 * 32, NITEMS = I_IN + I_PA + I_PB + I_O;
            for (int it = gw; it < NITEMS; it += NGW) {
                int r = it;
                if (r < I_IN) { const int kb = r / 272, nb = r - kb * 272; transpose_item(w_in, 8704, WIN, 1024, 0, win_dst_col(32 * nb), 64 * kb, 32 * nb, scr, lane); continue; } r -= I_IN;
                if (r < I_PA) { const int kb = r / 32, nb = r - kb * 32; transpose_item(w_pa, 1024, WAB, 1024, 0, 32 * nb, 64 * kb, 32 * nb, scr, lane); continue; } r -= I_PA;
                if (r < I_PB) { const int kb = r / 32, nb = r - kb * 32; transpose_item(w_pb, 1024, WAB, 1024, 512, 32 * nb, 64 * kb, 32 * nb, scr, lane); continue; } r -= I_PB;
                { const int kb = r / 32, nb = r - kb * 32; transpose_item(w_o, 1024, WO, 1024, 0, 32 * nb, 64 * kb, 32 * nb, scr, lane); }
            }
        }
        for (int n = blk * 512 + tid; n < 8704; n += G * 512) BIASP[win_dst_col(n)] = b_in[n];
        for (int i = blk * 512 + tid; i < 128 * 29 * 128; i += G * 512) { const int b = i / (29 * 128), r = i - b * (29 * 128), row = r >> 7, c4 = r & 127;
            *(f32x4*)(out + pg8::O_CONVS + ((size_t)b * 30 + row) * 512 + c4 * 4) = *(const f32x4*)(st_conv + ((size_t)b * 30 + row + 1) * 512 + c4 * 4); }
        if (BOTH(0)) GRID_BAR();
    }

    if (IN(1)) {
        for (int m = gw; m < pg8::MPAD; m += NGW) {
            unsigned long long* o8 = (unsigned long long*)(H + (size_t)m * 1024) + lane;
            if (m >= pg8::MROWS) {
#pragma unroll
                for (int j = 0; j < 4; ++j) o8[64 * j] = 0ull;
                continue; }
            const float* xr = (m < pg8::SEQ) ? x_p + (size_t)m * 1024 : x_s + (size_t)(m - pg8::SEQ) * 1024;
            const float* md = MOD + ((m < pg8::SEQ) ? 0 : (size_t)(1 + m - pg8::SEQ) * 3072);
#pragma unroll
            for (int j = 0; j < 4; ++j) { const int c = 4 * lane + 256 * j; const f32x4 xv = *(const f32x4*)(xr + c), sh = *(const f32x4*)(md + c), scv = *(const f32x4*)(md + 1024 + c);
                const f32x4 hv = xv * (scv + 1.0f) + sh;
                o8[64 * j] = (unsigned long long)pk2(hv[0], hv[1]) | ((unsigned long long)pk2(hv[2], hv[3]) << 32); }
        }
        if (BOTH(1)) GRID_BAR();
    }

    if (IN(2)) {
        pg8::Gemm g{H, WIN, pg8::MPAD, 8704, 1024}; pg8::StaticOrder S; S.init(pg8::MPAD, 8704, G, blk);
        pg8::EpiMain E{Z, BIASP, out};
        pg8::gemm_phase<pg8::EpiMain, pg8::StaticOrder, true, true>(lds, g, S, E);
        if (BOTH(2)) GRID_BAR();
    }

    if (IN(3)) {
        const bool sample_first = (blk & 1) != 0;
#define SAMPLE_UNITS() do { for (int u = wave * G + blk; u < 1536; u += NGW) { const int b = u / 12, gh = u - b * 12, g = gh >> 2, h = gh & 3; \
            att::sample_unit(Z, g == 0 ? cache0 : (g == 1 ? cache1 : cache2), g == 0 ? 128 : (g == 1 ? 512 : 2048), OG, LSE, b, g, h, lane); } } while (0)
        if (sample_first) SAMPLE_UNITS();
        for (int u = blk; u < 768; u += G) att::prompt_unit(lds, Z, OG, LSE, u);
        if (!sample_first) SAMPLE_UNITS();
#undef SAMPLE_UNITS
        if (BOTH(3)) GRID_BAR();
    }

    if (IN(4)) {
        LAS float* cwl = (LAS float*)lds;
        for (int i = tid; i < 31 * 512; i += NWAVES * 64) cwl[i] = conv_w[i];
        for (int i = tid; i < 512; i += NWAVES * 64) { cwl[31 * 512 + i] = conv_b[i]; cwl[32 * 512 + i] = cn_g[i]; cwl[33 * 512 + i] = cn_b[i]; }
        __syncthreads();
        const int c8 = lane * 8, jh = lane >> 4;
        for (int m = gw; m < pg8::MPAD; m += NGW) {
            v4u* arow = (v4u*)(A12 + (size_t)m * 1024);
            if (m >= pg8::MROWS) { arow[lane] = (v4u){0u, 0u, 0u, 0u}; arow[64 + lane] = (v4u){0u, 0u, 0u, 0u}; continue; }
            const bf16* zr = Z + (size_t)m * 8192;
            {
                const float l0 = LSE[((size_t)0 * pg8::MPAD + m) * 4 + jh], l1 = LSE[((size_t)1 * pg8::MPAD + m) * 4 + jh], l2 = LSE[((size_t)2 * pg8::MPAD + m) * 4 + jh];
                const float mx = fmaxf(l0, fmaxf(l1, l2));
                float w0 = __builtin_amdgcn_exp2f(l0 - mx), w1 = __builtin_amdgcn_exp2f(l1 - mx), w2 = __builtin_amdgcn_exp2f(l2 - mx);
                const float rs = __builtin_amdgcn_rcpf(w0 + w1 + w2); w0 *= rs; w1 *= rs; w2 *= rs;
                const v4u o0 = *(const v4u*)(OG + ((size_t)0 * pg8::MPAD + m) * 512 + c8), o1 = *(const v4u*)(OG + ((size_t)1 * pg8::MPAD + m) * 512 + c8), o2 = *(const v4u*)(OG + ((size_t)2 * pg8::MPAD + m) * 512 + c8);
                const v4u ga = *(const v4u*)(zr + pg8::ZGA + c8);
                v4u r;
#define CMB(F) pk2((w0 * pg8::bf_lo(o0.F) + w1 * pg8::bf_lo(o1.F) + w2 * pg8::bf_lo(o2.F)) * pg8::bf_lo(ga.F), (w0 * pg8::bf_hi(o0.F) + w1 * pg8::bf_hi(o1.F) + w2 * pg8::bf_hi(o2.F)) * pg8::bf_hi(ga.F))
                r.x = CMB(x); r.y = CMB(y); r.z = CMB(z); r.w = CMB(w);
#undef CMB
                arow[lane] = r;
            }
            {
                float y[8];
#pragma unroll
                for (int e = 0; e < 8; ++e) y[e] = cwl[31 * 512 + c8 + e];
                if (m < pg8::SEQ) {
#pragma unroll 4
                    for (int w = 0; w < 31; ++w) { const int t = m - 30 + w;
                        if (t >= 0) { const v4u uv = *(const v4u*)(Z + (size_t)t * 8192 + pg8::ZU + c8); const LAS float* cw = cwl + w * 512 + c8;
                            y[0] += pg8::bf_lo(uv.x) * cw[0]; y[1] += pg8::bf_hi(uv.x) * cw[1]; y[2] += pg8::bf_lo(uv.y) * cw[2]; y[3] += pg8::bf_hi(uv.y) * cw[3];
                            y[4] += pg8::bf_lo(uv.z) * cw[4]; y[5] += pg8::bf_hi(uv.z) * cw[5]; y[6] += pg8::bf_lo(uv.w) * cw[6]; y[7] += pg8::bf_hi(uv.w) * cw[7]; } }
                } else {
                    const float* sp = st_conv + (size_t)(m - pg8::SEQ) * 30 * 512 + c8;
#pragma unroll 5
                    for (int w = 0; w < 30; ++w) { const f32x4 a = *(const f32x4*)(sp + (size_t)w * 512), b = *(const f32x4*)(sp + (size_t)w * 512 + 4); const LAS float* cw = cwl + w * 512 + c8;
                        y[0] += a[0] * cw[0]; y[1] += a[1] * cw[1]; y[2] += a[2] * cw[2]; y[3] += a[3] * cw[3]; y[4] += b[0] * cw[4]; y[5] += b[1] * cw[5]; y[6] += b[2] * cw[6]; y[7] += b[3] * cw[7]; }
                    { const v4u uv = *(const v4u*)(zr + pg8::ZU + c8); const LAS float* cw = cwl + 30 * 512 + c8;
                        y[0] += pg8::bf_lo(uv.x) * cw[0]; y[1] += pg8::bf_hi(uv.x) * cw[1]; y[2] += pg8::bf_lo(uv.y) * cw[2]; y[3] += pg8::bf_hi(uv.y) * cw[3];
                        y[4] += pg8::bf_lo(uv.z) * cw[4]; y[5] += pg8::bf_hi(uv.z) * cw[5]; y[6] += pg8::bf_lo(uv.w) * cw[6]; y[7] += pg8::bf_hi(uv.w) * cw[7]; }
                }
                float s = 0.f;
#pragma unroll
                for (int e = 0; e < 8; ++e) s += y[e];
                const float mean = wave_sum(s) * (1.f / 512.f); float q = 0.f;
#pragma unroll
                for (int e = 0; e < 8; ++e) { y[e] -= mean; q += y[e] * y[e]; }
                const float rstd = 1.f / sqrtf(wave_sum(q) * (1.f / 512.f) + 1e-5f);
                const v4u gb = *(const v4u*)(zr + pg8::ZGB + c8);
                float gbf[8] = {pg8::bf_lo(gb.x), pg8::bf_hi(gb.x), pg8::bf_lo(gb.y), pg8::bf_hi(gb.y), pg8::bf_lo(gb.z), pg8::bf_hi(gb.z), pg8::bf_lo(gb.w), pg8::bf_hi(gb.w)};
#pragma unroll
                for (int e = 0; e < 8; ++e) { const float yn = y[e] * rstd * cwl[32 * 512 + c8 + e] + cwl[33 * 512 + c8 + e]; y[e] = yn * pg8::sigmoidf_(yn) * gbf[e]; }
                v4u r; r.x = pk2(y[0], y[1]); r.y = pk2(y[2], y[3]); r.z = pk2(y[4], y[5]); r.w = pk2(y[6], y[7]);
                arow[64 + lane] = r;
            }
        }
        __syncthreads();
        if (BOTH(4)) GRID_BAR();
    }

    if (IN(5)) {
        pg8::Gemm g{A12, WAB, pg8::MPAD, 1024, 1024}; pg8::StaticOrder S; S.init(pg8::MPAD, 1024, G, blk);
        pg8::EpiAB E{Z, MB};
        pg8::gemm_phase<pg8::EpiAB, pg8::StaticOrder, true, true>(lds, g, S, E);
        if (BOTH(5)) GRID_BAR();
    }

    if (IN(6)) {
        pg8::Gemm g{MB, WO, pg8::MPAD, 1024, 1024}; pg8::StaticOrder S; S.init(pg8::MPAD, 1024, G, blk);
        pg8::EpiO E{x_p, x_s, MOD, out};
        pg8::gemm_phase<pg8::EpiO, pg8::StaticOrder, true, true>(lds, g, S, E);
        if (BOTH(6)) GRID_BAR();
    }

    if (IN(7)) {
        for (int m = gw; m < pg8::MROWS; m += NGW) {
            float* row = (m < pg8::SEQ) ? out + pg8::O_YP + (size_t)m * 1024 : out + pg8::O_YS + (size_t)(m - pg8::SEQ) * 1024;
            f32x4 v[4]; float s = 0.f;
#pragma unroll
            for (int j = 0; j < 4; ++j) { v[j] = *(const f32x4*)(row + 4 * lane + 256 * j); s += (v[j][0] + v[j][1]) + (v[j][2] + v[j][3]); }
            const float mean = wave_sum(s) * (1.f / 1024.f); float q = 0.f;
#pragma unroll
            for (int j = 0; j < 4; ++j) { v[j] = v[j] - mean; q += (v[j][0] * v[j][0] + v[j][1] * v[j][1]) + (v[j][2] * v[j][2] + v[j][3] * v[j][3]); }
            const float rstd = 1.f / sqrtf(wave_sum(q) * (1.f / 1024.f) + 1e-5f);
#pragma unroll
            for (int j = 0; j < 4; ++j) { const int c = 4 * lane + 256 * j; const f32x4 gv = *(const f32x4*)(ln_g + c), bv = *(const f32x4*)(ln_b + c);
                *(f32x4*)(row + c) = v[j] * rstd * gv + bv; }
        }
    }
#undef IN
#undef BOTH
#undef GRID_BAR
}

extern "C" void kernel_launch(void* const* d_in, const int* in_sizes, int n_in, void* d_out, int out_size, void* d_ws, size_t ws_size, hipStream_t stream) {
    static int grid = 0;
    if (grid == 0) {
        if (n_in != 21 || out_size != (int)pg8::O_TOTAL || ws_size < WS_END) { fprintf(stderr, "kernel_launch: shape mismatch: n_in %d out %d ws %zu\n", n_in, out_size, ws_size); grid = -1; return; }
        int dev = 0, cus = 0, per_cu = 0;
        if (hipGetDevice(&dev) != hipSuccess || hipDeviceGetAttribute(&cus, hipDeviceAttributeMultiprocessorCount, dev) != hipSuccess) { grid = -1; return; }
        if (hipFuncSetAttribute((const void*)fwd_kernel, hipFuncAttributeMaxDynamicSharedMemorySize, LDS_BYTES) != hipSuccess) { fprintf(stderr, "kernel_launch: hipFuncSetAttribute failed\n"); grid = -1; return; }
        if (hipOccupancyMaxActiveBlocksPerMultiprocessor(&per_cu, (const void*)fwd_kernel, NWAVES * 64, LDS_BYTES) != hipSuccess || per_cu < 1) { fprintf(stderr, "kernel_launch: occupancy query says %d blocks per CU\n", per_cu); }
        (void)hipGetLastError();
        grid = cus;
    }
    if (grid < 0) return;
    if (hipMemsetAsync((char*)d_ws + WS_CTL, 0, CTL_ZERO_BYTES, stream) != hipSuccess) { fprintf(stderr, "kernel_launch: memset failed\n"); return; }
    Args a{};
    for (int i = 0; i < 21; ++i) a.in[i] = (const float*)d_in[i];
    a.out = (float*)d_out; a.ws = (unsigned char*)d_ws;
    for (int li = 0; li < N_LAUNCHES; ++li) {
        a.ph_lo = (N_LAUNCHES == 1) ? 0 : li; a.ph_hi = (N_LAUNCHES == 1) ? NPHASE : li + 1;
        hipLaunchKernelGGL(fwd_kernel, dim3(grid), dim3(NWAVES * 64), LDS_BYTES, stream, a);
        const hipError_t le = hipPeekAtLastError();
        if (le != hipSuccess) { fprintf(stderr, "kernel_launch: launch %d failed: %s\n", li, hipGetErrorName(le)); break; }
    }
}
```
